# Optimizing an MI355X kernel written in HIP

```python
import math
import jax
import jax.numpy as jnp
from jax import lax
import numpy as np


D_MODEL = 1024
BATCH = 4
SEQ = 8192
DEPTH = 2

MEM_LEN = 256
N_MIXERS = 4
GROUP_WIDTH = D_MODEL // N_MIXERS
DIL_HEADS = 4
DIL_HEAD_DIM = GROUP_WIDTH // DIL_HEADS
DIL_BRANCHES = ((128, 1), (512, 4), (2048, 16))
ATTN_BLOCK = 128
RET_HEADS = 4
RET_DK = GROUP_WIDTH // RET_HEADS
RET_DV = GROUP_WIDTH // RET_HEADS
RET_CHUNK = 128
GLA_HEADS = 4
GLA_DV = GROUP_WIDTH // GLA_HEADS
GLA_DK = GLA_DV // 2
GLA_GATE_RANK = 16
GLA_TAU = 16.0
GLA_CHUNK = 64
S5_CH = 16
S5_GROUPS = GROUP_WIDTH // S5_CH
S5_STATE = 64
S5_DT_MIN = 1e-3
S5_DT_MAX = 1e-1
MEM_HEADS = 4
MEM_HEAD_DIM = D_MODEL // MEM_HEADS
D_FF = (8 * D_MODEL + 767) // 768 * 256
DEEPNORM_ALPHA = (2 * DEPTH) ** 0.25
DEEPNORM_BETA = (8 * DEPTH) ** -0.25
LN_EPS = 1e-5
NEG_INF = -1e30

IN_SIZES = (
    GROUP_WIDTH, GROUP_WIDTH, GROUP_WIDTH,
    RET_HEADS * RET_DK, RET_HEADS * RET_DK, RET_HEADS * RET_DV,
    RET_HEADS * RET_DV,
    GLA_HEADS * GLA_DK, GLA_HEADS * GLA_DK, GLA_HEADS * GLA_DV,
    GLA_GATE_RANK, GLA_HEADS * GLA_DV,
    GROUP_WIDTH,
)
D_IN = sum(IN_SIZES)

kernel_name = 'hybrid_dilated_ret_gla_s5_block'


def layer_norm(x, g, b):
    xf = x.astype(jnp.float32)
    mu = xf.mean(-1, keepdims=True)
    var = jnp.square(xf - mu).mean(-1, keepdims=True)
    return ((xf - mu) * lax.rsqrt(var + LN_EPS) * g + b).astype(x.dtype)


def head_norm(o, g):
    mu = o.mean(-1, keepdims=True)
    var = jnp.square(o - mu).mean(-1, keepdims=True)
    return (o - mu) * lax.rsqrt(var + LN_EPS) * g.reshape(o.shape[-2], o.shape[-1])


def chunk_state_scan(chunk_decay, u):
    def step(r, inp):
        a, uc = inp
        return a[..., None] * r + uc, r
    r0 = jnp.zeros(u.shape[:1] + u.shape[2:], u.dtype)
    _, prev = lax.scan(step, r0, (jnp.moveaxis(chunk_decay, 1, 0), jnp.moveaxis(u, 1, 0)))
    return jnp.moveaxis(prev, 0, 1)


def dilated_branch(q, k, v, window, dilation, slopes):
    bsz, seq, heads, hd = q.shape
    band = window // dilation
    n_prev = -(-band // ATTN_BLOCK)
    span = dilation * ATTN_BLOCK
    seq_pad = -(-seq // span) * span
    nb = seq_pad // span
    kw_len = (n_prev + 1) * ATTN_BLOCK

    def to_sub(t):
        t = jnp.pad(t, ((0, 0), (0, seq_pad - seq), (0, 0), (0, 0)))
        return t.reshape(bsz, nb, ATTN_BLOCK, dilation, heads, hd)

    def key_window(t):
        t = jnp.pad(t, ((0, 0), (n_prev, 0), (0, 0), (0, 0), (0, 0), (0, 0)))
        return jnp.concatenate([t[:, i:i + nb] for i in range(n_prev + 1)], axis=2)

    qs = to_sub(q)
    ks = key_window(to_sub(k))
    vs = key_window(to_sub(v))
    s = jnp.einsum('bnqrhd,bnkrhd->bnrhqk', qs, ks).astype(jnp.float32) * (hd ** -0.5)
    qi = jnp.arange(ATTN_BLOCK)[:, None]
    ki = jnp.arange(kw_len)[None, :]
    dist = qi + n_prev * ATTN_BLOCK - ki
    key_pos = jnp.arange(nb)[:, None] * ATTN_BLOCK - n_prev * ATTN_BLOCK + jnp.arange(kw_len)[None, :]
    valid = ((dist >= 0) & (dist <= band))[None] & (key_pos >= 0)[:, None, :]
    alibi = -slopes[:, None, None] * (dist * dilation).astype(jnp.float32)[None]
    s = jnp.where(valid[None, :, None, None], s + alibi, NEG_INF)
    m = s.max(-1, keepdims=True)
    p = jnp.exp(s - m)
    l = p.sum(-1)
    o = jnp.einsum('bnrhqk,bnkrhd->bnqrhd', p.astype(v.dtype), vs)
    inv = jnp.transpose(1.0 / l, (0, 1, 4, 2, 3))
    o = o * inv[..., None].astype(o.dtype)
    lse = jnp.transpose(m[..., 0] + jnp.log(l), (0, 1, 4, 2, 3))
    o = o.reshape(bsz, seq_pad, heads, hd)[:, :seq]
    lse = lse.reshape(bsz, seq_pad, heads)[:, :seq]
    return o, lse


def dilated_attention(q, k, v):
    bsz, seq, heads, hd = q.shape
    slopes = 2.0 ** (-8.0 * jnp.arange(1, heads + 1, dtype=jnp.float32) / heads)
    results = [dilated_branch(q, k, v, w, r, slopes) for (w, r) in DIL_BRANCHES]
    outs = jnp.stack([o for o, _ in results]).astype(jnp.float32)
    lses = jnp.stack([z for _, z in results])
    wts = jax.nn.softmax(lses, axis=0)
    o = jnp.sum(wts[..., None] * outs, axis=0)
    return o.reshape(bsz, seq, heads * hd).astype(q.dtype)


def retention(q, k, v, gate, gn_g):
    bsz, seq, heads, dk = q.shape
    dv = v.shape[-1]
    c = RET_CHUNK
    nc = seq // c
    log_g = jnp.log(1.0 - 2.0 ** (-5.0 - jnp.arange(heads, dtype=jnp.float32)))
    qc = q.reshape(bsz, nc, c, heads, dk)
    kc = k.reshape(bsz, nc, c, heads, dk) * (dk ** -0.5)
    vc = v.reshape(bsz, nc, c, heads, dv)
    pos = jnp.arange(c, dtype=jnp.float32)
    rel = pos[:, None] - pos[None, :]
    decay = jnp.where(rel[None] >= 0, jnp.exp(jnp.maximum(rel, 0.0)[None] * log_g[:, None, None]), 0.0)
    scores = jnp.einsum('bcnhd,bcmhd->bchnm', qc, kc) * decay
    inner = jnp.einsum('bchnm,bcmhe->bcnhe', scores, vc)
    k_dec = kc * jnp.exp((c - 1 - pos)[:, None] * log_g[None, :])[..., None]
    u = jnp.einsum('bcmhd,bcmhe->bchde', k_dec, vc)
    chunk_decay = jnp.broadcast_to(jnp.exp(c * log_g)[:, None], (bsz, nc, heads, dk))
    r_prev = chunk_state_scan(chunk_decay, u)
    q_dec = qc * jnp.exp((pos + 1.0)[:, None] * log_g[None, :])[..., None]
    cross = jnp.einsum('bcnhd,bchde->bcnhe', q_dec, r_prev)
    o = (inner + cross).astype(jnp.float32).reshape(bsz, seq, heads, dv)
    o = head_norm(o, gn_g) * jax.nn.silu(gate.astype(jnp.float32)).reshape(bsz, seq, heads, dv)
    return o.reshape(bsz, seq, heads * dv).astype(q.dtype)


def gla(q, k, v, g_low, w_gate, b_gate, out_gate, gn_g):
    bsz, seq, heads, dk = q.shape
    dv = v.shape[-1]
    c = GLA_CHUNK
    nc = seq // c
    z = (g_low @ w_gate + b_gate).astype(jnp.float32)
    log_a = jax.nn.log_sigmoid(z).reshape(bsz, nc, c, heads, dk) / GLA_TAU
    b = jnp.cumsum(log_a, axis=2)
    qc = q.astype(jnp.float32).reshape(bsz, nc, c, heads, dk) * (dk ** -0.5)
    kc = k.astype(jnp.float32).reshape(bsz, nc, c, heads, dk)
    vc = v.astype(jnp.float32).reshape(bsz, nc, c, heads, dv)
    q_in = qc * jnp.exp(b)
    att = jnp.einsum('bcnhd,bcmhd->bchnm', q_in, kc * jnp.exp(-b))
    causal = jnp.tril(jnp.ones((c, c), dtype=bool))
    intra = jnp.einsum('bchnm,bcmhe->bcnhe', jnp.where(causal, att, 0.0), vc)
    b_last = b[:, :, -1:]
    u = jnp.einsum('bcmhd,bcmhe->bchde', kc * jnp.exp(b_last - b), vc)
    r_prev = chunk_state_scan(jnp.exp(b_last[:, :, 0]), u)
    cross = jnp.einsum('bcnhd,bchde->bcnhe', q_in, r_prev)
    o = (intra + cross).reshape(bsz, seq, heads, dv)
    o = head_norm(o, gn_g) * jax.nn.silu(out_gate.astype(jnp.float32)).reshape(bsz, seq, heads, dv)
    return o.reshape(bsz, seq, heads * dv).astype(q.dtype)


def s5_layer(u, a_re, a_im, log_dt, b_re, b_im, c_re, c_im, d, w_glu, b_glu):
    bsz, seq, _ = u.shape
    ug = u.astype(jnp.float32).reshape(bsz, seq, S5_GROUPS, S5_CH)
    dt = jnp.exp(log_dt.astype(jnp.float32))[:, None]
    ea = jnp.exp(a_re * dt)
    ab_re = ea * jnp.cos(a_im * dt)
    ab_im = ea * jnp.sin(a_im * dt)
    den = a_re * a_re + a_im * a_im
    nr = ab_re - 1.0
    f_re = (nr * a_re + ab_im * a_im) / den
    f_im = (ab_im * a_re - nr * a_im) / den
    bb_re = f_re[..., None] * b_re - f_im[..., None] * b_im
    bb_im = f_re[..., None] * b_im + f_im[..., None] * b_re
    bu_re = jnp.einsum('bsgi,gpi->bsgp', ug, bb_re)
    bu_im = jnp.einsum('bsgi,gpi->bsgp', ug, bb_im)
    at_re = jnp.broadcast_to(ab_re, bu_re.shape)
    at_im = jnp.broadcast_to(ab_im, bu_im.shape)

    def combine(e1, e2):
        a1r, a1i, b1r, b1i = e1
        a2r, a2i, b2r, b2i = e2
        return (a2r * a1r - a2i * a1i,
                a2r * a1i + a2i * a1r,
                a2r * b1r - a2i * b1i + b2r,
                a2r * b1i + a2i * b1r + b2i)

    _, _, x_re, x_im = lax.associative_scan(combine, (at_re, at_im, bu_re, bu_im), axis=1)
    y = (jnp.einsum('bsgp,gip->bsgi', x_re, c_re) - jnp.einsum('bsgp,gip->bsgi', x_im, c_im)
         + d * ug)
    y = jax.nn.gelu(y).reshape(bsz, seq, S5_GROUPS * S5_CH)
    out = y * jax.nn.sigmoid(y @ w_glu + b_glu)
    return out.astype(u.dtype)


def hybrid_mixer(x, w_in, ret_gn_g, gla_w_gate, gla_b_gate, gla_gn_g, s5_a_re, s5_a_im,
                 s5_log_dt, s5_b_re, s5_b_im, s5_c_re, s5_c_im, s5_d, s5_w_glu, s5_b_glu,
                 w_mix_out):
    bsz, seq, _ = x.shape
    proj = x @ w_in
    (dq, dk_, dv_, rq, rk, rv, rg, gq, gk, gv, glow, gog, su) = jnp.split(
        proj, np.cumsum(IN_SIZES)[:-1].tolist(), axis=-1)

    def heads(t, h):
        return t.reshape(bsz, seq, h, -1)

    y_a = dilated_attention(heads(dq, DIL_HEADS), heads(dk_, DIL_HEADS), heads(dv_, DIL_HEADS))
    y_b = retention(heads(rq, RET_HEADS), heads(rk, RET_HEADS), heads(rv, RET_HEADS), rg, ret_gn_g)
    y_c = gla(heads(gq, GLA_HEADS), heads(gk, GLA_HEADS), heads(gv, GLA_HEADS), glow,
              gla_w_gate, gla_b_gate, gog, gla_gn_g)
    y_d = s5_layer(su, s5_a_re, s5_a_im, s5_log_dt, s5_b_re, s5_b_im, s5_c_re, s5_c_im,
                   s5_d, s5_w_glu, s5_b_glu)
    y = jnp.concatenate([y_a, y_b, y_c, y_d], axis=-1)
    return y @ w_mix_out


def memory_cross_attention(x, mem, w_q, w_kv, w_o):
    bsz, seq, _ = x.shape
    q = (x @ w_q).reshape(bsz, seq, MEM_HEADS, MEM_HEAD_DIM)
    k, v = jnp.split(mem @ w_kv, 2, axis=-1)
    k = k.reshape(bsz, -1, MEM_HEADS, MEM_HEAD_DIM)
    v = v.reshape(bsz, -1, MEM_HEADS, MEM_HEAD_DIM)
    s = jnp.einsum('bshd,bmhd->bhsm', q, k).astype(jnp.float32) * (MEM_HEAD_DIM ** -0.5)
    p = jax.nn.softmax(s, axis=-1)
    o = jnp.einsum('bhsm,bmhd->bshd', p.astype(v.dtype), v).reshape(bsz, seq, D_MODEL)
    return o @ w_o


def swiglu_ffn(x, w_gate, w_up, w_down):
    return (jax.nn.silu(x @ w_gate) * (x @ w_up)) @ w_down


def setup_inputs(seed: int = 0) -> dict:
    key = jax.random.key(seed)
    ks = jax.random.split(key, 32)
    L, D, W = DEPTH, D_MODEL, GROUP_WIDTH
    G, P, CH = S5_GROUPS, S5_STATE, S5_CH
    f32 = jnp.float32

    def nrm(k, shape, scale):
        return scale * jax.random.normal(k, shape, f32)

    return {
        'x': nrm(ks[0], (BATCH, SEQ, D), 1.0),
        'mem': nrm(ks[1], (BATCH, MEM_LEN, D), 1.0),
        'w_in': nrm(ks[2], (L, D, D_IN), D ** -0.5),
        'ret_gn_g': 1.0 + nrm(ks[3], (L, RET_HEADS * RET_DV), 0.02),
        'gla_w_gate': nrm(ks[4], (L, GLA_GATE_RANK, GLA_HEADS * GLA_DK), GLA_GATE_RANK ** -0.5),
        'gla_b_gate': nrm(ks[5], (L, GLA_HEADS * GLA_DK), 0.1),
        'gla_gn_g': 1.0 + nrm(ks[6], (L, GLA_HEADS * GLA_DV), 0.02),
        's5_a_re': -0.5 + nrm(ks[7], (L, G, P), 0.01),
        's5_a_im': math.pi * jnp.arange(P, dtype=f32) + nrm(ks[8], (L, G, P), 0.01),
        's5_log_dt': jax.random.uniform(ks[9], (L, G), f32, math.log(S5_DT_MIN), math.log(S5_DT_MAX)),
        's5_b_re': nrm(ks[10], (L, G, P, CH), (2 * CH) ** -0.5),
        's5_b_im': nrm(ks[11], (L, G, P, CH), (2 * CH) ** -0.5),
        's5_c_re': nrm(ks[12], (L, G, CH, P), P ** -0.5),
        's5_c_im': nrm(ks[13], (L, G, CH, P), P ** -0.5),
        's5_d': nrm(ks[14], (L, G, CH), 1.0),
        's5_w_glu': nrm(ks[15], (L, W, W), W ** -0.5),
        's5_b_glu': nrm(ks[16], (L, W), 0.02),
        'w_mix_out': nrm(ks[17], (L, D, D), D ** -0.5 * DEEPNORM_BETA),
        'ln_mix_g': 1.0 + nrm(ks[18], (L, D), 0.02),
        'ln_mix_b': nrm(ks[19], (L, D), 0.02),
        'w_mem_q': nrm(ks[20], (L, D, D), D ** -0.5),
        'w_mem_kv': nrm(ks[21], (L, D, 2 * D), D ** -0.5),
        'w_mem_o': nrm(ks[22], (L, D, D), D ** -0.5 * DEEPNORM_BETA),
        'ln_mem_g': 1.0 + nrm(ks[23], (L, D), 0.02),
        'ln_mem_b': nrm(ks[24], (L, D), 0.02),
        'w_ff_gate': nrm(ks[25], (L, D, D_FF), D ** -0.5),
        'w_ff_up': nrm(ks[26], (L, D, D_FF), D ** -0.5),
        'w_ff_down': nrm(ks[27], (L, D_FF, D), D_FF ** -0.5 * DEEPNORM_BETA),
        'ln_ff_g': 1.0 + nrm(ks[28], (L, D), 0.02),
        'ln_ff_b': nrm(ks[29], (L, D), 0.02),
    }


def reference(x, mem, w_in, ret_gn_g, gla_w_gate, gla_b_gate, gla_gn_g, s5_a_re, s5_a_im,
              s5_log_dt, s5_b_re, s5_b_im, s5_c_re, s5_c_im, s5_d, s5_w_glu, s5_b_glu,
              w_mix_out, ln_mix_g, ln_mix_b, w_mem_q, w_mem_kv, w_mem_o, ln_mem_g, ln_mem_b,
              w_ff_gate, w_ff_up, w_ff_down, ln_ff_g, ln_ff_b):
    for l in range(DEPTH):
        h = hybrid_mixer(x, w_in[l], ret_gn_g[l], gla_w_gate[l], gla_b_gate[l], gla_gn_g[l],
                         s5_a_re[l], s5_a_im[l], s5_log_dt[l], s5_b_re[l], s5_b_im[l],
                         s5_c_re[l], s5_c_im[l], s5_d[l], s5_w_glu[l], s5_b_glu[l], w_mix_out[l])
        x = layer_norm(DEEPNORM_ALPHA * x + h, ln_mix_g[l], ln_mix_b[l])
        h = memory_cross_attention(x, mem, w_mem_q[l], w_mem_kv[l], w_mem_o[l])
        x = layer_norm(DEEPNORM_ALPHA * x + h, ln_mem_g[l], ln_mem_b[l])
        h = swiglu_ffn(x, w_ff_gate[l], w_ff_up[l], w_ff_down[l])
        x = layer_norm(DEEPNORM_ALPHA * x + h, ln_ff_g[l], ln_ff_b[l])
    return x
```

```cpp
#include <hip/hip_runtime.h>
#include <hip/hip_cooperative_groups.h>
#include <cstdio>
namespace cg = cooperative_groups;

#define LAS __attribute__((address_space(3)))
typedef unsigned short bf16_t;
typedef short bf16x8 __attribute__((ext_vector_type(8)));
typedef float f32x4 __attribute__((ext_vector_type(4)));
typedef unsigned u32x4 __attribute__((ext_vector_type(4)));
typedef unsigned u32x2 __attribute__((ext_vector_type(2)));

#ifndef MULTI_LAUNCH
#define MULTI_LAUNCH 0
#endif

constexpr int T = 32768, SEQ = 8192, DM = 1024, DINP = 3072, DFF = 2816;
constexpr float ALPHA = 1.41421356237f;
constexpr float LN_EPS = 1e-5f;
constexpr float LOG2E = 1.4426950408889634f, LN2 = 0.6931471805599453f;

constexpr size_t MiB = 1u << 20;
constexpr size_t WS_WIN = 0, WS_WMIX = 12 * MiB, WS_WKV = 16 * MiB, WS_WGU = 24 * MiB, WS_WD = 46 * MiB, WS_WGLU = 57 * MiB,
                 WS_MT = 58 * MiB, WS_NT = 74 * MiB, WS_S5E = 90 * MiB, WS_S5Y = 94 * MiB, WS_S5AB = 100 * MiB,
                 WS_XN = 101 * MiB, WS_Y = 165 * MiB, WS_PROJ = 229 * MiB, WS_UB = 421 * MiB, WS_UC = 437 * MiB, WS_DC = 453 * MiB,
                 WS_A5 = 454 * MiB, WS_E5 = 478 * MiB, WS_BAR = 494 * MiB, WS_END = 495 * MiB;
constexpr size_t WS_OA = WS_XN, WS_LSE = WS_XN + 48 * MiB;
constexpr size_t WS_MEMB = WS_PROJ, WS_WQN = WS_PROJ + 2 * MiB, WS_WOT = WS_PROJ + 6 * MiB, WS_KV = WS_PROJ + 10 * MiB;
constexpr int LDS_BYTES = 147456;
constexpr int XCH_OFF = 131072;

__device__ __forceinline__ unsigned f2bf(float f) { unsigned u = __builtin_bit_cast(unsigned, f); return (u + 0x7fffu + ((u >> 16) & 1u)) >> 16; }
__device__ __forceinline__ unsigned pk2(float lo, float hi) { unsigned r; asm("v_cvt_pk_bf16_f32 %0, %1, %2" : "=v"(r) : "v"(lo), "v"(hi)); return r; }
__device__ __forceinline__ float bflo(unsigned w) { return __builtin_bit_cast(float, w << 16); }
__device__ __forceinline__ float bfhi(unsigned w) { return __builtin_bit_cast(float, w & 0xffff0000u); }
__device__ __forceinline__ float bf2f(bf16_t b) { return __builtin_bit_cast(float, (unsigned)b << 16); }
__device__ __forceinline__ float ex2(float x) { return __builtin_amdgcn_exp2f(x); }
__device__ __forceinline__ float sigmoidf_(float x) { return __builtin_amdgcn_rcpf(1.f + __expf(-x)); }
__device__ __forceinline__ float siluf_(float x) { return x * __builtin_amdgcn_rcpf(1.f + __expf(-x)); }
__device__ __forceinline__ bf16x8 mk8(unsigned a, unsigned b, unsigned c, unsigned d) { u32x4 v = {a, b, c, d}; return __builtin_bit_cast(bf16x8, v); }
#define LDS_WAIT() asm volatile("s_waitcnt lgkmcnt(0)" ::: "memory")
#define MFMA16(a, b, c) __builtin_amdgcn_mfma_f32_16x16x32_bf16((a), (b), (c), 0, 0, 0)

struct Params { const float* in[30]; float* out; unsigned char* ws; };
struct KArgs { Params p; int lo, hi; };

namespace pg8 {
constexpr int BM = 256, BK = 64, HALF = 128, HTB = HALF * BK * 2, NXCD = 8, WGM = 8;
__device__ __forceinline__ int lds_byte(int r, int c) { const int st = (r >> 4) * 2 + (c >> 5), rr = r & 15, cc = c & 31, ob = rr * 64 + cc * 2; return st * 1024 + (ob ^ (((ob >> 9) & 1) << 5)); }
__device__ __forceinline__ void stage_rc(int b, int& R, int& C) { const int st = b / 1024, sb = b % 1024, swz = sb ^ (((sb >> 9) & 1) << 5); R = (st >> 1) * 16 + swz / 64; C = (st & 1) * 32 + (swz % 64) / 2; }
struct Unit { int pm, pn, z; };
struct Sched {
    int nM, nN, nwg, G, c;
    __device__ __forceinline__ void init(int nM_, int nN_, int nZ_, int G_, int c_) { nM = nM_; nN = nN_; nwg = nM_ * nN_ * nZ_; G = G_; c = c_; }
    __device__ __forceinline__ bool next(int i, Unit& u) const {
        const long L = (long)i * G + c; if (L >= nwg) return false;
        int wgid = (int)L; { const int q = nwg / NXCD, r = nwg % NXCD, xcd = wgid % NXCD, off = wgid / NXCD; wgid = (xcd < r ? xcd * (q + 1) : r * (q + 1) + (xcd - r) * q) + off; }
        const int per = nM * nN; u.z = wgid / per; const int w = wgid % per;
        const int nig = WGM * nN, gid = w / nig, fm = gid * WGM, gsz = (nM - fm) < WGM ? (nM - fm) : WGM;
        u.pm = fm + ((w % nig) % gsz); u.pn = (w % nig) / gsz; return true;
    }
};

template <class G, class Epi>
__device__ __forceinline__ void gemm_phase(LAS unsigned char* lds, const G g, const Sched& S, const Epi& E, const int wave_id) {
    int lane; asm volatile("v_mbcnt_lo_u32_b32 %0, -1, 0\n\tv_mbcnt_hi_u32_b32 %0, -1, %0" : "=v"(lane));
    const int wid = wave_id, tid = wid * 64 + lane, wr = wid >> 2, wc = wid & 3, fr = lane & 15, fq = lane >> 4;
    int K = g.K; asm volatile("" : "+s"(K)); const int nt = K / BK;
    unsigned voffA[2], voffB[2];
#pragma unroll
    for (int i = 0; i < 2; ++i) { int R, C; stage_rc(tid * 16 + i * 8192, R, C); voffA[i] = (unsigned)(R * g.lda + C) * 2u; voffB[i] = (unsigned)(R * g.ldb + C) * 2u; }
    const size_t kstep = (size_t)(BK * 2);
    const size_t hstepA = (size_t)HALF * g.lda * 2, hstepB = (size_t)HALF * g.ldb * 2;
    const unsigned ldsw = (unsigned)wid * 1024u;
    const int aoff = lds_byte(wr * 64 + fr, fq * 8), boff = lds_byte(wc * 32 + fr, fq * 8);
#define PG8_SA(b, h) (((b) * 2 + (h)) * HTB)
#define PG8_SB(b, h) ((4 + (b) * 2 + (h)) * HTB)
#define PG8_STAGE(bufoff, gbase, voff) do { _Pragma("unroll") for (int _i = 0; _i < 2; ++_i) \
        __builtin_amdgcn_global_load_lds((const unsigned*)((const char*)(gbase) + (voff)[_i]), (LAS unsigned*)(lds + (bufoff) + ldsw + _i * 8192), 16, 0, 0); } while (0)
#define PG8_LDA(dst, b, h) do { _Pragma("unroll") for (int m = 0; m < 4; ++m) _Pragma("unroll") for (int k = 0; k < 2; ++k) dst[m][k] = *(const LAS bf16x8*)(lds + PG8_SA(b, h) + aoff + m * 2048 + k * 1024); } while (0)
#define PG8_LDB(dst, b, h) do { _Pragma("unroll") for (int n = 0; n < 2; ++n) _Pragma("unroll") for (int k = 0; k < 2; ++k) dst[n][k] = *(const LAS bf16x8*)(lds + PG8_SB(b, h) + boff + n * 2048 + k * 1024); } while (0)
#define PG8_MMA(ai, bj, At, Bt) do { __builtin_amdgcn_s_setprio(1); _Pragma("unroll") for (int m = 0; m < 4; ++m) _Pragma("unroll") for (int n = 0; n < 2; ++n) _Pragma("unroll") for (int k = 0; k < 2; ++k) \
        acc[ai][bj][m][n] = __builtin_amdgcn_mfma_f32_16x16x32_bf16(Bt[n][k], At[m][k], acc[ai][bj][m][n], 0, 0, 0); __builtin_amdgcn_s_setprio(0); } while (0)
#define PG8_WAIT_V(n) asm volatile("s_waitcnt vmcnt(" #n ")" ::: "memory")
#define PG8_WAIT_L(n) asm volatile("s_waitcnt lgkmcnt(" #n ")" ::: "memory")
#define PG8_BAR __builtin_amdgcn_s_barrier()
#define PG8_SCHED __builtin_amdgcn_sched_barrier(0)
    Unit cur, nxt; int ui = 0;
    if (!S.next(0, cur)) return;
    f32x4 acc[2][2][4][2];
#pragma unroll
    for (int a = 0; a < 2; ++a)
#pragma unroll
        for (int b = 0; b < 2; ++b)
#pragma unroll
            for (int m = 0; m < 4; ++m)
#pragma unroll
                for (int n = 0; n < 2; ++n) acc[a][b][m][n] = (f32x4){0.f, 0.f, 0.f, 0.f};
    bf16x8 At[4][2], B0[2][2], B1[2][2];
    const char* cA = g.aptr(cur); const char* cB = g.bptr(cur);
    PG8_STAGE(PG8_SB(0, 0), cB, voffB); PG8_STAGE(PG8_SA(0, 0), cA, voffA); PG8_STAGE(PG8_SB(0, 1), cB + hstepB, voffB); PG8_STAGE(PG8_SA(0, 1), cA + hstepA, voffA);
    if (wr == 1) PG8_BAR;
    PG8_WAIT_V(4); PG8_BAR;
    PG8_STAGE(PG8_SB(1, 0), cB + kstep, voffB); PG8_STAGE(PG8_SA(1, 0), cA + kstep, voffA); PG8_STAGE(PG8_SB(1, 1), cB + hstepB + kstep, voffB);
    PG8_WAIT_V(6); PG8_BAR;
    for (;;) {
        const bool has_next = S.next(ui + 1, nxt);
        const char* nA = has_next ? g.aptr(nxt) : cA; const char* nB = has_next ? g.bptr(nxt) : cB;
        for (int t = 0; t < nt; t += 2) {
            const bool last = (t == nt - 2);
            const char* a1 = cA + (size_t)(t + 1) * kstep;
            const char* a2 = last ? nA : cA + (size_t)(t + 2) * kstep; const char* b2 = last ? nB : cB + (size_t)(t + 2) * kstep;
            const char* a3 = a2 + kstep; const char* b3 = b2 + kstep;
            PG8_LDB(B0, 0, 0); PG8_SCHED; PG8_LDA(At, 0, 0); PG8_STAGE(PG8_SA(1, 1), a1 + hstepA, voffA);
            PG8_WAIT_L(8); PG8_BAR; PG8_WAIT_L(0); PG8_MMA(0, 0, At, B0); PG8_BAR; PG8_SCHED;
            PG8_LDB(B1, 0, 1); PG8_STAGE(PG8_SB(0, 0), b2, voffB);
            PG8_BAR; PG8_WAIT_L(0); PG8_MMA(0, 1, At, B1); PG8_BAR;
            PG8_LDA(At, 0, 1); PG8_STAGE(PG8_SA(0, 0), a2, voffA);
            PG8_BAR; PG8_WAIT_L(0); PG8_MMA(1, 0, At, B0); PG8_BAR; PG8_SCHED;
            PG8_STAGE(PG8_SB(0, 1), b2 + hstepB, voffB);
            PG8_WAIT_V(6); PG8_BAR; PG8_MMA(1, 1, At, B1); PG8_BAR;
            PG8_LDB(B0, 1, 0); PG8_SCHED; PG8_LDA(At, 1, 0); PG8_STAGE(PG8_SA(0, 1), a2 + hstepA, voffA);
            PG8_WAIT_L(8); PG8_BAR; PG8_WAIT_L(0); PG8_MMA(0, 0, At, B0); PG8_BAR; PG8_SCHED;
            PG8_LDB(B1, 1, 1); PG8_STAGE(PG8_SB(1, 0), b3, voffB);
            PG8_BAR; PG8_WAIT_L(0); PG8_MMA(0, 1, At, B1); PG8_BAR;
            PG8_LDA(At, 1, 1); PG8_STAGE(PG8_SA(1, 0), a3, voffA);
            PG8_BAR; PG8_WAIT_L(0); PG8_MMA(1, 0, At, B0); PG8_BAR; PG8_SCHED;
            PG8_STAGE(PG8_SB(1, 1), b3 + hstepB, voffB);
            PG8_WAIT_V(6); PG8_BAR; PG8_MMA(1, 1, At, B1); PG8_BAR;
        }
        { int lane_e; asm volatile("v_mbcnt_lo_u32_b32 %0, -1, 0\n\tv_mbcnt_hi_u32_b32 %0, -1, %0" : "=v"(lane_e)); E(acc, cur, wr, wc, lane_e & 15, lane_e >> 4, lds); }
        if (!has_next) break;
#pragma unroll
        for (int a = 0; a < 2; ++a)
#pragma unroll
            for (int b = 0; b < 2; ++b)
#pragma unroll
                for (int m = 0; m < 4; ++m)
#pragma unroll
                    for (int n = 0; n < 2; ++n) acc[a][b][m][n] = (f32x4){0.f, 0.f, 0.f, 0.f};
        cur = nxt; cA = nA; cB = nB; ++ui;
    }
    PG8_WAIT_V(0);
    if (wr == 0) PG8_BAR;
    PG8_BAR;
#undef PG8_SA
#undef PG8_SB
#undef PG8_STAGE
#undef PG8_LDA
#undef PG8_LDB
#undef PG8_MMA
#undef PG8_WAIT_V
#undef PG8_WAIT_L
#undef PG8_BAR
#undef PG8_SCHED
}
}
using pg8::Unit;

#define EPI_WALK(...) _Pragma("unroll") for (int ai = 0; ai < 2; ++ai) _Pragma("unroll") for (int m = 0; m < 4; ++m) _Pragma("unroll") for (int bj = 0; bj < 2; ++bj) _Pragma("unroll") for (int n = 0; n < 2; ++n) { \
        const int trow = ai * 128 + wr * 64 + m * 16 + fr, tcol = bj * 128 + wc * 32 + n * 16 + 4 * fq; const f32x4 v = acc[ai][bj][m][n]; __VA_ARGS__ }
typedef f32x4 Acc[2][2][4][2];

struct GPlain {
    const bf16_t* A; const bf16_t* B; int lda, ldb, K;
    __device__ __forceinline__ const char* aptr(const Unit& u) const { return (const char*)(A + (size_t)u.pm * 256 * lda); }
    __device__ __forceinline__ const char* bptr(const Unit& u) const { return (const char*)(B + (size_t)u.pn * 256 * ldb); }
};
struct GBatchB {
    const bf16_t* A; const bf16_t* B; int lda, ldb, K;
    __device__ __forceinline__ const char* aptr(const Unit& u) const { return (const char*)(A + (size_t)(u.z * 32 + u.pm) * 256 * 1024); }
    __device__ __forceinline__ const char* bptr(const Unit& u) const { return (const char*)(B + ((size_t)u.z * 1024 + u.pn * 256) * 1024); }
};
struct GKV {
    const bf16_t* A; const bf16_t* B; int lda, ldb, K;
    __device__ __forceinline__ const char* aptr(const Unit& u) const { return (const char*)(A + (size_t)u.pm * 256 * 1024); }
    __device__ __forceinline__ const char* bptr(const Unit& u) const { return (const char*)(B + ((size_t)u.z * 2048 + u.pn * 256) * 1024); }
};
struct GMT {
    const bf16_t* A; const bf16_t* B; int lda, ldb, K;
    __device__ __forceinline__ const char* aptr(const Unit& u) const { const int h = u.z & 3, lb = u.z >> 2; return (const char*)(A + (size_t)lb * 256 * 2048 + h * 256); }
    __device__ __forceinline__ const char* bptr(const Unit& u) const { const int h = u.z & 3, l = u.z >> 4; return (const char*)(B + ((size_t)l * 1024 + u.pn * 256) * 1024 + h * 256); }
};
struct GNT {
    const bf16_t* A; const bf16_t* B; int lda, ldb, K;
    __device__ __forceinline__ const char* aptr(const Unit& u) const { const int h = u.z & 3, l = u.z >> 4; return (const char*)(A + ((size_t)l * 1024 + u.pm * 256) * 1024 + h * 256); }
    __device__ __forceinline__ const char* bptr(const Unit& u) const { const int h = u.z & 3, lb = u.z >> 2; return (const char*)(B + (size_t)lb * 256 * 2048 + 1024 + h * 256); }
};
struct GS5 {
    const bf16_t* A; const bf16_t* B; int lda, ldb, K;
    __device__ __forceinline__ const char* aptr(const Unit& u) const { return (const char*)(A + ((size_t)u.z * 2048 + u.pm * 256) * 384); }
    __device__ __forceinline__ const char* bptr(const Unit& u) const { return (const char*)(B + (size_t)u.z * 256 * ldb); }
};

__device__ __forceinline__ void st_bf4(bf16_t* p, f32x4 v) { u32x2 w = {pk2(v[0], v[1]), pk2(v[2], v[3])}; *(u32x2*)p = w; }

struct EpiProj {
    bf16_t* proj; bf16_t* a5;
    __device__ __forceinline__ void operator()(const Acc& acc, const Unit& u, int wr, int wc, int fr, int fq, LAS unsigned char*) const {
        const bool su = (u.pn == 10);
        EPI_WALK( const int row = u.pm * 256 + trow, b = row >> 13, t = row & 8191;
                  const unsigned o1 = (unsigned)(row * DINP + u.pn * 256 + tcol), o2 = (unsigned)((((tcol >> 4) * 2048 + b * 512 + (t >> 4)) * 384) + (t & 15) * 16 + (tcol & 15));
                  bf16_t* dst = su ? (a5 + o2) : (proj + o1); st_bf4(dst, v); )
    }
};
struct EpiBf16 {
    bf16_t* C; int ldc; int kind;
    __device__ __forceinline__ void operator()(const Acc& acc, const Unit& u, int wr, int wc, int fr, int fq, LAS unsigned char*) const {
        size_t base;
        if (kind == 0) base = ((size_t)u.z * 1024 + u.pm * 256) * 2048 + u.pn * 256;
        else if (kind == 1) { const int h = u.z & 3, lb = u.z >> 2; base = ((size_t)lb * 1024 + h * 256) * 1024 + u.pn * 256; }
        else { const int h = u.z & 3, lb = u.z >> 2; base = ((size_t)lb * 1024 + u.pm * 256) * 1024 + h * 256; }
        EPI_WALK( st_bf4(C + base + (size_t)trow * ldc + tcol, v); )
    }
};
struct EpiResid {
    const float* xsrc; float* out; int zrows;
    __device__ __forceinline__ void operator()(const Acc& acc, const Unit& u, int wr, int wc, int fr, int fq, LAS unsigned char*) const {
        const int r0 = (u.z * zrows + u.pm) * 256;
        EPI_WALK( const unsigned o = (unsigned)((r0 + trow) * DM + u.pn * 256 + tcol); const f32x4 x = *(const f32x4*)(xsrc + o); *(f32x4*)(out + o) = x * ALPHA + v; )
    }
};
struct EpiSwiGLU {
    bf16_t* H;
    __device__ __forceinline__ void operator()(const Acc& acc, const Unit& u, int wr, int wc, int fr, int fq, LAS unsigned char*) const {
#pragma unroll
        for (int ai = 0; ai < 2; ++ai)
#pragma unroll
            for (int m = 0; m < 4; ++m)
#pragma unroll
                for (int n = 0; n < 2; ++n) {
                    const int trow = ai * 128 + wr * 64 + m * 16 + fr, c = wc * 32 + n * 16 + 4 * fq; const f32x4 gt = acc[ai][0][m][n], up = acc[ai][1][m][n]; f32x4 hv;
#pragma unroll
                    for (int j = 0; j < 4; ++j) hv[j] = siluf_(gt[j]) * up[j];
                    st_bf4(H + (unsigned)((u.pm * 256 + trow) * DFF + u.pn * 128 + c), hv);
                }
    }
};
struct EpiSoftmax {
    bf16_t* P;
    __device__ __forceinline__ void operator()(const Acc& acc, const Unit& u, int wr, int wc, int fr, int fq, LAS unsigned char* lds) const {
        const float sc = 0.0625f * LOG2E;
        LAS float* X = (LAS float*)(lds + XCH_OFF);
        float mx[2][4], ls[2][4];
#pragma unroll
        for (int ai = 0; ai < 2; ++ai)
#pragma unroll
            for (int m = 0; m < 4; ++m) {
                float a = -3.0e38f;
#pragma unroll
                for (int bj = 0; bj < 2; ++bj)
#pragma unroll
                    for (int n = 0; n < 2; ++n)
#pragma unroll
                        for (int j = 0; j < 4; ++j) a = fmaxf(a, acc[ai][bj][m][n][j]);
                a = fmaxf(a, __shfl_xor(a, 16)); a = fmaxf(a, __shfl_xor(a, 32));
                a *= sc; float s = 0.f;
#pragma unroll
                for (int bj = 0; bj < 2; ++bj)
#pragma unroll
                    for (int n = 0; n < 2; ++n)
#pragma unroll
                        for (int j = 0; j < 4; ++j) s += ex2(acc[ai][bj][m][n][j] * sc - a);
                s += __shfl_xor(s, 16); s += __shfl_xor(s, 32);
                mx[ai][m] = a; ls[ai][m] = s;
                const int trow = ai * 128 + wr * 64 + m * 16 + fr;
                if (fq == 0) { X[(trow * 4 + wc) * 2] = a; X[(trow * 4 + wc) * 2 + 1] = s; }
            }
        LDS_WAIT(); __builtin_amdgcn_s_barrier();
#pragma unroll
        for (int ai = 0; ai < 2; ++ai)
#pragma unroll
            for (int m = 0; m < 4; ++m) {
                const int trow = ai * 128 + wr * 64 + m * 16 + fr;
                float gm = -3.0e38f; float mm[4], ll[4];
#pragma unroll
                for (int w = 0; w < 4; ++w) { mm[w] = X[(trow * 4 + w) * 2]; ll[w] = X[(trow * 4 + w) * 2 + 1]; gm = fmaxf(gm, mm[w]); }
                float gl = 0.f;
#pragma unroll
                for (int w = 0; w < 4; ++w) gl += ll[w] * ex2(mm[w] - gm);
                const float inv = 1.f / gl;
#pragma unroll
                for (int bj = 0; bj < 2; ++bj)
#pragma unroll
                    for (int n = 0; n < 2; ++n) {
                        f32x4 pv;
#pragma unroll
                        for (int j = 0; j < 4; ++j) pv[j] = ex2(acc[ai][bj][m][n][j] * sc - gm) * inv;
                        st_bf4(P + (unsigned)(((u.z * 32 + u.pm) * 256 + trow) * DM + u.pn * 256 + bj * 128 + wc * 32 + n * 16 + 4 * fq), pv);
                    }
            }
    }
};
struct EpiS5E {
    float* E5;
    __device__ __forceinline__ void operator()(const Acc& acc, const Unit& u, int wr, int wc, int fr, int fq, LAS unsigned char*) const {
#pragma unroll
        for (int ai = 0; ai < 2; ++ai)
#pragma unroll
            for (int m = 0; m < 4; ++m)
#pragma unroll
                for (int n = 0; n < 2; ++n) {
                    const int trow = ai * 128 + wr * 64 + m * 16 + fr, c = wc * 32 + n * 16 + 4 * fq;
                    *(f32x4*)(E5 + ((size_t)u.z * 2048 + u.pm * 256 + trow) * 128 + c) = acc[ai][0][m][n];
                }
    }
};
__device__ __forceinline__ float gelu_tanh(float y) { const float t = 1.5957691216057308f * (y + 0.044715f * y * y * y); return y * __builtin_amdgcn_rcpf(1.f + __expf(-t)); }
struct EpiS5Y {
    bf16_t* Y;
    __device__ __forceinline__ void operator()(const Acc& acc, const Unit& u, int wr, int wc, int fr, int fq, LAS unsigned char*) const {
        EPI_WALK( const int bc = u.pm * 256 + trow, b = bc >> 9, c = bc & 511, s = tcol >> 4, i = tcol & 15; f32x4 y;
                  _Pragma("unroll") for (int j = 0; j < 4; ++j) y[j] = gelu_tanh(v[j]);
                  st_bf4(Y + (unsigned)((b * 8192 + c * 16 + s) * DM + 768 + u.z * 16 + i), y); )
    }
};
struct EpiGLU {
    bf16_t* Y; const float* bglu;
    __device__ __forceinline__ void operator()(const Acc& acc, const Unit& u, int wr, int wc, int fr, int fq, LAS unsigned char*) const {
        EPI_WALK( bf16_t* p = Y + (unsigned)((u.pm * 256 + trow) * DM + 768 + tcol); const u32x2 yw = *(const u32x2*)p; const f32x4 bb = *(const f32x4*)(bglu + tcol);
                  f32x4 o; o[0] = bflo(yw[0]) * sigmoidf_(v[0] + bb[0]); o[1] = bfhi(yw[0]) * sigmoidf_(v[1] + bb[1]); o[2] = bflo(yw[1]) * sigmoidf_(v[2] + bb[2]); o[3] = bfhi(yw[1]) * sigmoidf_(v[3] + bb[3]);
                  st_bf4(p, o); if (bj == 1 && n == 1) __builtin_amdgcn_sched_barrier(0); )
    }
};

__device__ __forceinline__ int rowmap(int mode, int n) {
    if (mode == 1) return n < 2304 ? n : (n < 2320 ? n + 512 : n - 16);
    if (mode == 2) return ((n >> 7) << 8) + (n & 127);
    if (mode == 3) return ((n >> 7) << 8) + 128 + (n & 127);
    return n;
}
__device__ __forceinline__ void tr_item(const float* W, int K, int N, bf16_t* WT, int ldt, int mode, LAS float* scr, int item, int lane) {
    const int nblk = (N + 31) / 32, kb = item / nblk, nb = item % nblk, k0 = 64 * kb, n0 = 32 * nb;
    const int nn = n0 + (lane & 31); const bool ok = nn < N;
#pragma unroll 8
    for (int i = 0; i < 32; ++i) { const int kk = 2 * i + (lane >> 5); scr[kk * 33 + (lane & 31)] = ok ? W[(size_t)(k0 + kk) * N + nn] : 0.f; }
    LDS_WAIT(); asm volatile("" ::: "memory");
    const int c = lane & 7;
#pragma unroll
    for (int j = 0; j < 4; ++j) { const int n = (lane >> 3) + 8 * j; const LAS float* s = scr + (8 * c) * 33 + n;
        u32x4 o; o.x = pk2(s[0 * 33], s[1 * 33]); o.y = pk2(s[2 * 33], s[3 * 33]); o.z = pk2(s[4 * 33], s[5 * 33]); o.w = pk2(s[6 * 33], s[7 * 33]);
        if (n0 + n < N) *(u32x4*)(WT + (size_t)rowmap(mode, n0 + n) * ldt + k0 + 8 * c) = o; }
    LDS_WAIT(); asm volatile("" ::: "memory");
}
__device__ __forceinline__ void cvt_plain(const float* src, bf16_t* dst, size_t n8, size_t gtid, size_t gsz) {
    for (size_t i = gtid; i < n8; i += gsz) { const f32x4 a = *(const f32x4*)(src + i * 8), b = *(const f32x4*)(src + i * 8 + 4);
        u32x4 o = {pk2(a[0], a[1]), pk2(a[2], a[3]), pk2(b[0], b[1]), pk2(b[2], b[3])}; *(u32x4*)(dst + i * 8) = o; }
}

__device__ __forceinline__ void s5_setup(const Params& p, LAS unsigned char* lds, int lg, int tid) {
    LAS float* PW = (LAS float*)lds;
    LAS float* BB = (LAS float*)(lds + 8704);
    LAS float* KK = (LAS float*)(lds + 16896);
    LAS float* CC = (LAS float*)(lds + 33280);
    bf16_t* BY = (bf16_t*)(p.ws + WS_S5Y) + (size_t)lg * 256 * 384;
    bf16_t* BE = (bf16_t*)(p.ws + WS_S5E) + (size_t)lg * 256 * 256;
    float* AB16 = (float*)(p.ws + WS_S5AB) + (size_t)lg * 128;
    if (tid < 64) {
        const int pp = tid; const float dt = expf(p.in[9][lg]);
        const float are = p.in[7][lg * 64 + pp], aim = p.in[8][lg * 64 + pp];
        const float ea = expf(are * dt), abr = ea * cosf(aim * dt), abi = ea * sinf(aim * dt);
        const float den = are * are + aim * aim, nr = abr - 1.f;
        const float fre = (nr * are + abi * aim) / den, fim = (abi * are - nr * aim) / den;
        for (int i = 0; i < 16; ++i) { const float br = p.in[10][(lg * 64 + pp) * 16 + i], bi = p.in[11][(lg * 64 + pp) * 16 + i];
            BB[(pp * 16 + i) * 2] = fre * br - fim * bi; BB[(pp * 16 + i) * 2 + 1] = fre * bi + fim * br; }
        float pr = 1.f, pi = 0.f;
        for (int k = 0; k <= 16; ++k) { PW[(k * 64 + pp) * 2] = pr; PW[(k * 64 + pp) * 2 + 1] = pi; const float nr2 = pr * abr - pi * abi, ni2 = pr * abi + pi * abr; pr = nr2; pi = ni2; }
        AB16[pp] = PW[(16 * 64 + pp) * 2]; AB16[64 + pp] = PW[(16 * 64 + pp) * 2 + 1];
    }
    for (int i = tid; i < 1024; i += 512) { const int io = i >> 6, pp = i & 63; CC[i * 2] = p.in[12][(lg * 16 + io) * 64 + pp]; CC[i * 2 + 1] = p.in[13][(lg * 16 + io) * 64 + pp]; }
    __syncthreads();
    for (int e = tid; e < 4096; e += 512) { const int k = e >> 8, io = (e >> 4) & 15, ii = e & 15; float s = 0.f;
        for (int pp = 0; pp < 64; ++pp) { const float cr = CC[(io * 64 + pp) * 2], ci = CC[(io * 64 + pp) * 2 + 1], pr = PW[(k * 64 + pp) * 2], pi = PW[(k * 64 + pp) * 2 + 1];
            const float xr = cr * pr - ci * pi, xi = cr * pi + ci * pr; s += xr * BB[(pp * 16 + ii) * 2] - xi * BB[(pp * 16 + ii) * 2 + 1]; }
        if (k == 0 && io == ii) s += p.in[14][lg * 16 + io];
        KK[e] = s; }
    __syncthreads();
    for (int idx = tid; idx < 256 * 384; idx += 512) { const int n = idx / 384, k = idx % 384, t = n >> 4, io = n & 15; float val;
        if (k < 256) { const int s = k >> 4, ii = k & 15; val = (s <= t) ? KK[((t - s) * 16 + io) * 16 + ii] : 0.f; }
        else { const int pp = (k - 256) & 63; const float cr = CC[(io * 64 + pp) * 2], ci = CC[(io * 64 + pp) * 2 + 1], pr = PW[((t + 1) * 64 + pp) * 2], pi = PW[((t + 1) * 64 + pp) * 2 + 1];
            val = (k < 320) ? (cr * pr - ci * pi) : -(cr * pi + ci * pr); }
        BY[idx] = (bf16_t)f2bf(val); }
    for (int idx = tid; idx < 256 * 256; idx += 512) { const int n = idx >> 8, k = idx & 255; float val = 0.f;
        if (n < 128) { const int ri = n >> 6, pp = n & 63, s = k >> 4, ii = k & 15; const float pr = PW[((15 - s) * 64 + pp) * 2], pi = PW[((15 - s) * 64 + pp) * 2 + 1], br = BB[(pp * 16 + ii) * 2], bi = BB[(pp * 16 + ii) * 2 + 1];
            val = ri ? (pr * bi + pi * br) : (pr * br - pi * bi); }
        BE[idx] = (bf16_t)f2bf(val); }
    __syncthreads();
}

__device__ __forceinline__ void phase_prologue(const Params& p, LAS unsigned char* lds, int tid, int lane, int wave) {
    const int G = gridDim.x, bx = blockIdx.x;
    const size_t gtid = (size_t)bx * 512 + tid, gsz = (size_t)G * 512;
    unsigned char* ws = p.ws;
    cvt_plain(p.in[0], (bf16_t*)(ws + WS_XN), (size_t)T * DM / 8, gtid, gsz);
    cvt_plain(p.in[1], (bf16_t*)(ws + WS_MEMB), (size_t)1024 * 1024 / 8, gtid, gsz);
    cvt_plain(p.in[20], (bf16_t*)(ws + WS_WQN), (size_t)2 * 1024 * 1024 / 8, gtid, gsz);
    for (size_t i = gtid; i < (size_t)2 * 240 * 1024 / 8; i += gsz) { const size_t l = i / (240 * 128), r = i % (240 * 128);
        *(u32x4*)((bf16_t*)(ws + WS_WIN) + (l * 3072 + 2832) * 1024 + r * 8) = (u32x4){0u, 0u, 0u, 0u}; }
    LAS float* scr = (LAS float*)(lds + 50176 + wave * 8448);
    const int gw = bx * 8 + wave, NGW = G * 8;
    constexpr int I_IN = 89 * 16, I_MIX = 512, I_KV = 1024, I_O = 512, I_G = 88 * 16, I_D = 32 * 44, I_GLU = 32;
    constexpr int PER_L = I_IN + I_MIX + I_KV + I_O + 2 * I_G + I_D + I_GLU;
    for (int it = gw; it < 2 * PER_L; it += NGW) {
        const int l = it / PER_L; int r = it % PER_L;
        if (r < I_IN) { tr_item(p.in[2] + (size_t)l * 1024 * 2832, 1024, 2832, (bf16_t*)(ws + WS_WIN) + (size_t)l * 3072 * 1024, 1024, 1, scr, r, lane); continue; } r -= I_IN;
        if (r < I_MIX) { tr_item(p.in[17] + (size_t)l * 1024 * 1024, 1024, 1024, (bf16_t*)(ws + WS_WMIX) + (size_t)l * 1024 * 1024, 1024, 0, scr, r, lane); continue; } r -= I_MIX;
        if (r < I_KV) { tr_item(p.in[21] + (size_t)l * 1024 * 2048, 1024, 2048, (bf16_t*)(ws + WS_WKV) + (size_t)l * 2048 * 1024, 1024, 0, scr, r, lane); continue; } r -= I_KV;
        if (r < I_O) { tr_item(p.in[22] + (size_t)l * 1024 * 1024, 1024, 1024, (bf16_t*)(ws + WS_WOT) + (size_t)l * 1024 * 1024, 1024, 0, scr, r, lane); continue; } r -= I_O;
        if (r < I_G) { tr_item(p.in[25] + (size_t)l * 1024 * 2816, 1024, 2816, (bf16_t*)(ws + WS_WGU) + (size_t)l * 5632 * 1024, 1024, 2, scr, r, lane); continue; } r -= I_G;
        if (r < I_G) { tr_item(p.in[26] + (size_t)l * 1024 * 2816, 1024, 2816, (bf16_t*)(ws + WS_WGU) + (size_t)l * 5632 * 1024, 1024, 3, scr, r, lane); continue; } r -= I_G;
        if (r < I_D) { tr_item(p.in[27] + (size_t)l * 2816 * 1024, 2816, 1024, (bf16_t*)(ws + WS_WD) + (size_t)l * 1024 * 2816, 2816, 0, scr, r, lane); continue; } r -= I_D;
        tr_item(p.in[15] + (size_t)l * 256 * 256, 256, 256, (bf16_t*)(ws + WS_WGLU) + (size_t)l * 256 * 256, 256, 0, scr, r, lane);
    }
    __syncthreads();
    for (int lg = bx; lg < 32; lg += G) s5_setup(p, lds, lg, tid);
}

__device__ __forceinline__ void attn_task(const Params& p, LAS unsigned char* lds, int task, int tid, int lane, int w) {
    const bf16_t* proj = (const bf16_t*)(p.ws + WS_PROJ);
    bf16_t* OA = (bf16_t*)(p.ws + WS_OA); float* LSE = (float*)(p.ws + WS_LSE);
    const int br = task >> 10, rem = task & 1023, b = rem >> 8, h = (rem >> 6) & 3, blk = rem & 63;
    const int r = (br == 0) ? 1 : (br == 1 ? 4 : 16), n = blk / r, c = blk % r;
    LAS unsigned char* Qs = lds; LAS unsigned char* Ks = lds + 18432; LAS unsigned char* Vt = lds + 55296;
    {
        const int row = tid >> 2, part = tid & 3; const size_t tok = (size_t)b * SEQ + (size_t)(n * 128 + row) * r + c;
        const u32x4* src = (const u32x4*)(proj + tok * DINP + h * 64 + part * 16);
        const u32x4 a0 = src[0], a1 = src[1];
        *(LAS u32x4*)(Qs + (row * 72 + part * 16) * 2) = a0; *(LAS u32x4*)(Qs + (row * 72 + part * 16 + 8) * 2) = a1;
    }
    {
        const int row = tid >> 1, part = tid & 1; const int sub = (n - 1) * 128 + row;
        u32x4 k4[4], v4[4];
        if (sub >= 0) { const size_t tok = (size_t)b * SEQ + (size_t)sub * r + c; const u32x4* ks = (const u32x4*)(proj + tok * DINP + 256 + h * 64 + part * 32); const u32x4* vs = (const u32x4*)(proj + tok * DINP + 512 + h * 64 + part * 32);
#pragma unroll
            for (int i = 0; i < 4; ++i) { k4[i] = ks[i]; v4[i] = vs[i]; } }
        else {
#pragma unroll
            for (int i = 0; i < 4; ++i) { k4[i] = (u32x4){0u, 0u, 0u, 0u}; v4[i] = (u32x4){0u, 0u, 0u, 0u}; } }
#pragma unroll
        for (int i = 0; i < 4; ++i) *(LAS u32x4*)(Ks + (row * 72 + part * 32 + i * 8) * 2) = k4[i];
#pragma unroll
        for (int i = 0; i < 4; ++i)
#pragma unroll
            for (int e = 0; e < 4; ++e) { const unsigned wv = v4[i][e]; const int d = part * 32 + i * 8 + e * 2;
                *(LAS bf16_t*)(Vt + (d * 264 + row) * 2) = (bf16_t)(wv & 0xffffu); *(LAS bf16_t*)(Vt + ((d + 1) * 264 + row) * 2) = (bf16_t)(wv >> 16); }
    }
    __syncthreads();
    const int c16 = lane & 15, g = lane >> 4;
    bf16x8 qf[2];
#pragma unroll
    for (int ks = 0; ks < 2; ++ks) qf[ks] = *(const LAS bf16x8*)(Qs + ((16 * w + c16) * 72 + ks * 32 + g * 8) * 2);
    f32x4 s[9];
#pragma unroll
    for (int k9 = 0; k9 < 9; ++k9) { s[k9] = (f32x4){0.f, 0.f, 0.f, 0.f};
#pragma unroll
        for (int ks = 0; ks < 2; ++ks) { const bf16x8 a = *(const LAS bf16x8*)(Ks + (((w + k9) * 16 + c16) * 72 + ks * 32 + g * 8) * 2); s[k9] = MFMA16(a, qf[ks], s[k9]); } }
    const float slope = ex2(-2.f * (float)(h + 1));
    const float c1 = 0.125f * LOG2E, c2 = slope * (float)r * LOG2E;
    float mx = -3.0e38f;
#pragma unroll
    for (int k9 = 0; k9 < 9; ++k9)
#pragma unroll
        for (int j = 0; j < 4; ++j) { const int dist = c16 + 128 - 16 * k9 - 4 * g - j; const int kk = 16 * (w + k9) + 4 * g + j;
            const bool valid = (dist >= 0) && (dist <= 128) && (n > 0 || kk >= 128);
            const float v = valid ? (s[k9][j] * c1 - c2 * (float)dist) : -3.0e38f; s[k9][j] = v; mx = fmaxf(mx, v); }
    mx = fmaxf(mx, __shfl_xor(mx, 16)); mx = fmaxf(mx, __shfl_xor(mx, 32));
    float l = 0.f;
#pragma unroll
    for (int k9 = 0; k9 < 9; ++k9)
#pragma unroll
        for (int j = 0; j < 4; ++j) { const float pv = (s[k9][j] > -1.0e38f) ? ex2(s[k9][j] - mx) : 0.f; s[k9][j] = pv; l += pv; }
    l += __shfl_xor(l, 16); l += __shfl_xor(l, 32);
    f32x4 o[4];
#pragma unroll
    for (int db = 0; db < 4; ++db) o[db] = (f32x4){0.f, 0.f, 0.f, 0.f};
#pragma unroll
    for (int pr = 0; pr < 5; ++pr) {
        const int kb0 = w + 2 * pr; int kb1 = kb0 + 1; if (kb1 > 15) kb1 = 15;
        bf16x8 pb;
        if (pr < 4) pb = mk8(pk2(s[2 * pr][0], s[2 * pr][1]), pk2(s[2 * pr][2], s[2 * pr][3]), pk2(s[2 * pr + 1][0], s[2 * pr + 1][1]), pk2(s[2 * pr + 1][2], s[2 * pr + 1][3]));
        else pb = mk8(pk2(s[8][0], s[8][1]), pk2(s[8][2], s[8][3]), 0u, 0u);
#pragma unroll
        for (int db = 0; db < 4; ++db) {
            const u32x2 lo = *(const LAS u32x2*)(Vt + ((db * 16 + c16) * 264 + kb0 * 16 + g * 4) * 2), hi = *(const LAS u32x2*)(Vt + ((db * 16 + c16) * 264 + kb1 * 16 + g * 4) * 2);
            o[db] = MFMA16(mk8(lo[0], lo[1], hi[0], hi[1]), pb, o[db]); }
    }
    const float inv = 1.f / l;
    const size_t tokq = (size_t)b * SEQ + (size_t)(n * 128 + 16 * w + c16) * r + c;
#pragma unroll
    for (int db = 0; db < 4; ++db) st_bf4(OA + ((size_t)br * T + tokq) * 256 + h * 64 + db * 16 + g * 4, o[db] * inv);
    if (g == 0) LSE[((size_t)br * T + tokq) * 4 + h] = (mx + __log2f(l)) * LN2;
    __syncthreads();
}

__device__ __forceinline__ float ret_log2g(int h) { return __log2f(1.f - ex2(-5.f - (float)h)); }

__device__ __forceinline__ void ret1_task(const Params& p, LAS unsigned char* lds, int task, int tid, int lane, int w) {
    const bf16_t* proj = (const bf16_t*)(p.ws + WS_PROJ); float* UB = (float*)(p.ws + WS_UB);
    const int b = task >> 8, c = (task >> 2) & 63, h = task & 3;
    LAS unsigned char* VT = lds; LAS unsigned char* KT = lds + 17408;
    const float l2g = ret_log2g(h);
    {
        const int m = tid >> 2, part = tid & 3; const size_t tok = (size_t)b * SEQ + c * 128 + m;
        const u32x4* ks = (const u32x4*)(proj + tok * DINP + 1024 + h * 64 + part * 16); const u32x4* vs = (const u32x4*)(proj + tok * DINP + 1280 + h * 64 + part * 16);
        const float sc = 0.125f * ex2((float)(127 - m) * l2g);
#pragma unroll
        for (int i = 0; i < 2; ++i) { const u32x4 kv = ks[i], vv = vs[i];
#pragma unroll
            for (int e = 0; e < 4; ++e) { const int d = part * 16 + i * 8 + e * 2;
                *(LAS bf16_t*)(KT + (d * 136 + m) * 2) = (bf16_t)f2bf(bflo(kv[e]) * sc); *(LAS bf16_t*)(KT + ((d + 1) * 136 + m) * 2) = (bf16_t)f2bf(bfhi(kv[e]) * sc);
                *(LAS bf16_t*)(VT + (d * 136 + m) * 2) = (bf16_t)(vv[e] & 0xffffu); *(LAS bf16_t*)(VT + ((d + 1) * 136 + m) * 2) = (bf16_t)(vv[e] >> 16); } }
    }
    __syncthreads();
    const int c16 = lane & 15, g = lane >> 4, eb = w >> 1;
    f32x4 acc[2] = {(f32x4){0.f, 0.f, 0.f, 0.f}, (f32x4){0.f, 0.f, 0.f, 0.f}};
#pragma unroll
    for (int ks = 0; ks < 4; ++ks) { const bf16x8 a = *(const LAS bf16x8*)(VT + ((eb * 16 + c16) * 136 + ks * 32 + g * 8) * 2);
#pragma unroll
        for (int x = 0; x < 2; ++x) { const int db = 2 * (w & 1) + x; const bf16x8 bfr = *(const LAS bf16x8*)(KT + ((db * 16 + c16) * 136 + ks * 32 + g * 8) * 2); acc[x] = MFMA16(a, bfr, acc[x]); } }
    float* dst = UB + (size_t)((b * 64 + c) * 4 + h) * 4096;
#pragma unroll
    for (int x = 0; x < 2; ++x) { const int db = 2 * (w & 1) + x;
#pragma unroll
        for (int j = 0; j < 4; ++j) dst[(eb * 16 + g * 4 + j) * 64 + db * 16 + c16] = acc[x][j]; }
    __syncthreads();
}

__device__ __forceinline__ void head_norm_store(f32x4 (&o)[4], const float* gn, const bf16_t* gate, bf16_t* dst, int g) {
    float s = 0.f;
#pragma unroll
    for (int eb = 0; eb < 4; ++eb) s += (o[eb][0] + o[eb][1]) + (o[eb][2] + o[eb][3]);
    s += __shfl_xor(s, 16); s += __shfl_xor(s, 32);
    const float mu = s * (1.f / 64.f); float q = 0.f;
#pragma unroll
    for (int eb = 0; eb < 4; ++eb)
#pragma unroll
        for (int j = 0; j < 4; ++j) { const float d = o[eb][j] - mu; q += d * d; }
    q += __shfl_xor(q, 16); q += __shfl_xor(q, 32);
    const float rstd = rsqrtf(q * (1.f / 64.f) + LN_EPS);
#pragma unroll
    for (int eb = 0; eb < 4; ++eb) { const int e = eb * 16 + g * 4; const f32x4 gg = *(const f32x4*)(gn + e); const u32x2 gw = *(const u32x2*)(gate + e);
        f32x4 r; r[0] = (o[eb][0] - mu) * rstd * gg[0] * siluf_(bflo(gw[0])); r[1] = (o[eb][1] - mu) * rstd * gg[1] * siluf_(bfhi(gw[0]));
        r[2] = (o[eb][2] - mu) * rstd * gg[2] * siluf_(bflo(gw[1])); r[3] = (o[eb][3] - mu) * rstd * gg[3] * siluf_(bfhi(gw[1]));
        st_bf4(dst + e, r); }
}

__device__ __forceinline__ void ret3_task(const Params& p, LAS unsigned char* lds, int l, int task, int tid, int lane, int w) {
    const bf16_t* proj = (const bf16_t*)(p.ws + WS_PROJ); const float* UB = (const float*)(p.ws + WS_UB); bf16_t* Y = (bf16_t*)(p.ws + WS_Y);
    const int b = task >> 8, c = (task >> 2) & 63, h = task & 3;
    LAS unsigned char* Qs = lds; LAS unsigned char* Ks = lds + 18432; LAS unsigned char* VT = lds + 36864; LAS unsigned char* RT = lds + 54272;
    const float l2g = ret_log2g(h);
    {
        const int m = tid >> 2, part = tid & 3; const size_t tok = (size_t)b * SEQ + c * 128 + m; const bf16_t* row = proj + tok * DINP + h * 64 + part * 16;
        const u32x4* qs = (const u32x4*)(row + 768); const u32x4* ks = (const u32x4*)(row + 1024); const u32x4* vs = (const u32x4*)(row + 1280);
#pragma unroll
        for (int i = 0; i < 2; ++i) { *(LAS u32x4*)(Qs + (m * 72 + part * 16 + i * 8) * 2) = qs[i]; *(LAS u32x4*)(Ks + (m * 72 + part * 16 + i * 8) * 2) = ks[i]; const u32x4 vv = vs[i];
#pragma unroll
            for (int e = 0; e < 4; ++e) { const int d = part * 16 + i * 8 + e * 2; *(LAS bf16_t*)(VT + (d * 136 + m) * 2) = (bf16_t)(vv[e] & 0xffffu); *(LAS bf16_t*)(VT + ((d + 1) * 136 + m) * 2) = (bf16_t)(vv[e] >> 16); } }
        const int e = tid >> 3, d0 = (tid & 7) * 8; const float* rs = UB + (size_t)((b * 64 + c) * 4 + h) * 4096 + e * 64 + d0; const f32x4 r0 = *(const f32x4*)rs, r1 = *(const f32x4*)(rs + 4);
        *(LAS u32x4*)(RT + (e * 72 + d0) * 2) = (u32x4){pk2(r0[0], r0[1]), pk2(r0[2], r0[3]), pk2(r1[0], r1[1]), pk2(r1[2], r1[3])};
    }
    __syncthreads();
    const int c16 = lane & 15, g = lane >> 4, nn = 16 * w + c16;
    bf16x8 qf[2];
#pragma unroll
    for (int ks = 0; ks < 2; ++ks) qf[ks] = *(const LAS bf16x8*)(Qs + (nn * 72 + ks * 32 + g * 8) * 2);
    f32x4 o[4];
    const float gq = ex2((float)(nn + 1) * l2g);
#pragma unroll
    for (int eb = 0; eb < 4; ++eb) { o[eb] = (f32x4){0.f, 0.f, 0.f, 0.f};
#pragma unroll
        for (int ks = 0; ks < 2; ++ks) { const bf16x8 a = *(const LAS bf16x8*)(RT + ((eb * 16 + c16) * 72 + ks * 32 + g * 8) * 2); o[eb] = MFMA16(a, qf[ks], o[eb]); }
        o[eb] = o[eb] * gq; }
    for (int pr = 0; 2 * pr <= w; ++pr) {
        f32x4 s2[2];
#pragma unroll
        for (int x = 0; x < 2; ++x) { const int kb = 2 * pr + x; s2[x] = (f32x4){0.f, 0.f, 0.f, 0.f};
#pragma unroll
            for (int ks = 0; ks < 2; ++ks) { const bf16x8 a = *(const LAS bf16x8*)(Ks + ((kb * 16 + c16) * 72 + ks * 32 + g * 8) * 2); s2[x] = MFMA16(a, qf[ks], s2[x]); }
#pragma unroll
            for (int j = 0; j < 4; ++j) { const int diff = nn - (16 * kb + 4 * g + j); s2[x][j] = (diff >= 0) ? s2[x][j] * 0.125f * ex2((float)diff * l2g) : 0.f; } }
        const bf16x8 pb = mk8(pk2(s2[0][0], s2[0][1]), pk2(s2[0][2], s2[0][3]), pk2(s2[1][0], s2[1][1]), pk2(s2[1][2], s2[1][3]));
#pragma unroll
        for (int eb = 0; eb < 4; ++eb) { const u32x2 lo = *(const LAS u32x2*)(VT + ((eb * 16 + c16) * 136 + (2 * pr) * 16 + g * 4) * 2), hi = *(const LAS u32x2*)(VT + ((eb * 16 + c16) * 136 + (2 * pr + 1) * 16 + g * 4) * 2);
            o[eb] = MFMA16(mk8(lo[0], lo[1], hi[0], hi[1]), pb, o[eb]); }
    }
    const size_t tok = (size_t)b * SEQ + c * 128 + nn;
    head_norm_store(o, p.in[3] + l * 256 + h * 64, proj + tok * DINP + 1536 + h * 64, Y + tok * DM + 256 + h * 64, g);
    __syncthreads();
}

__device__ __forceinline__ void gla_gates(const Params& p, int l, LAS float* BC, LAS float* GL, size_t tok0, int tid) {
    const bf16_t* proj = (const bf16_t*)(p.ws + WS_PROJ);
    if (tid < 128) { const int m = tid >> 1, half = tid & 1; const u32x4 gv = *(const u32x4*)(proj + (tok0 + m) * DINP + 2816 + half * 8);
#pragma unroll
        for (int e = 0; e < 4; ++e) { GL[m * 16 + half * 8 + e * 2] = bflo(gv[e]); GL[m * 16 + half * 8 + e * 2 + 1] = bfhi(gv[e]); } }
    __syncthreads();
    {
        const int col = tid & 127, mg = tid >> 7; float wc_[16];
#pragma unroll
        for (int r = 0; r < 16; ++r) wc_[r] = p.in[4][(l * 16 + r) * 128 + col];
        const float bg = p.in[5][l * 128 + col];
        for (int mi = 0; mi < 16; ++mi) { const int m = mg * 16 + mi; float z = bg;
#pragma unroll
            for (int r = 0; r < 16; ++r) z += GL[m * 16 + r] * wc_[r];
            const float ls = fminf(z, 0.f) - log1pf(__expf(-fabsf(z)));
            BC[m * 128 + col] = ls * (1.f / 16.f); }
    }
    __syncthreads();
    if (tid < 128) { float run = 0.f; for (int m = 0; m < 64; ++m) { run += BC[m * 128 + tid]; BC[m * 128 + tid] = run; } }
    __syncthreads();
}

__device__ __forceinline__ void gla1_task(const Params& p, LAS unsigned char* lds, int l, int task, int tid, int lane, int w) {
    const bf16_t* proj = (const bf16_t*)(p.ws + WS_PROJ); float* UC = (float*)(p.ws + WS_UC); float* DC = (float*)(p.ws + WS_DC);
    const int b = task >> 7, c = task & 127; const size_t tok0 = (size_t)b * SEQ + c * 64;
    LAS float* BC = (LAS float*)lds; LAS float* GL = (LAS float*)(lds + 32768); LAS unsigned char* KT = lds + 36864; LAS unsigned char* VT = lds + 55296;
    gla_gates(p, l, BC, GL, tok0, tid);
    {
        const int m = tid >> 3, part = tid & 7;
        const u32x4* ks = (const u32x4*)(proj + (tok0 + m) * DINP + 1920 + part * 16);
#pragma unroll
        for (int i = 0; i < 2; ++i) { const u32x4 kv = ks[i];
#pragma unroll
            for (int e = 0; e < 4; ++e) { const int col = part * 16 + i * 8 + e * 2;
                const float s0 = __expf(BC[63 * 128 + col] - BC[m * 128 + col]), s1 = __expf(BC[63 * 128 + col + 1] - BC[m * 128 + col + 1]);
                *(LAS bf16_t*)(KT + (col * 72 + m) * 2) = (bf16_t)f2bf(bflo(kv[e]) * s0); *(LAS bf16_t*)(KT + ((col + 1) * 72 + m) * 2) = (bf16_t)f2bf(bfhi(kv[e]) * s1); } }
        const u32x4* vs = (const u32x4*)(proj + (tok0 + m) * DINP + 2048 + part * 32);
#pragma unroll
        for (int i = 0; i < 4; ++i) { const u32x4 vv = vs[i];
#pragma unroll
            for (int e = 0; e < 4; ++e) { const int col = part * 32 + i * 8 + e * 2; *(LAS bf16_t*)(VT + (col * 72 + m) * 2) = (bf16_t)(vv[e] & 0xffffu); *(LAS bf16_t*)(VT + ((col + 1) * 72 + m) * 2) = (bf16_t)(vv[e] >> 16); } }
        if (tid < 128) DC[(size_t)(b * 128 + c) * 128 + tid] = __expf(BC[63 * 128 + tid]);
    }
    __syncthreads();
    const int c16 = lane & 15, g = lane >> 4, h = w >> 1;
    f32x4 acc[2][2];
#pragma unroll
    for (int x = 0; x < 2; ++x)
#pragma unroll
        for (int y = 0; y < 2; ++y) acc[x][y] = (f32x4){0.f, 0.f, 0.f, 0.f};
#pragma unroll
    for (int ks = 0; ks < 2; ++ks) { bf16x8 a[2], bb[2];
#pragma unroll
        for (int x = 0; x < 2; ++x) { const int eb = 2 * (w & 1) + x; a[x] = *(const LAS bf16x8*)(VT + ((h * 64 + eb * 16 + c16) * 72 + ks * 32 + g * 8) * 2); }
#pragma unroll
        for (int y = 0; y < 2; ++y) bb[y] = *(const LAS bf16x8*)(KT + ((h * 32 + y * 16 + c16) * 72 + ks * 32 + g * 8) * 2);
#pragma unroll
        for (int x = 0; x < 2; ++x)
#pragma unroll
            for (int y = 0; y < 2; ++y) acc[x][y] = MFMA16(a[x], bb[y], acc[x][y]); }
    float* dst = UC + (size_t)((b * 128 + c) * 4 + h) * 2048;
#pragma unroll
    for (int x = 0; x < 2; ++x) { const int eb = 2 * (w & 1) + x;
#pragma unroll
        for (int y = 0; y < 2; ++y)
#pragma unroll
            for (int j = 0; j < 4; ++j) dst[(eb * 16 + g * 4 + j) * 32 + y * 16 + c16] = acc[x][y][j]; }
    __syncthreads();
}

__device__ __forceinline__ void gla3_task(const Params& p, LAS unsigned char* lds, int l, int task, int tid, int lane, int w) {
    const bf16_t* proj = (const bf16_t*)(p.ws + WS_PROJ); const float* UC = (const float*)(p.ws + WS_UC); bf16_t* Y = (bf16_t*)(p.ws + WS_Y);
    const int b = task >> 7, c = task & 127; const size_t tok0 = (size_t)b * SEQ + c * 64;
    LAS float* BC = (LAS float*)lds; LAS float* GL = (LAS float*)(lds + 32768);
    LAS unsigned char* Qi = lds + 36864; LAS unsigned char* Ko = lds + 54272; LAS unsigned char* VT = lds + 71680; LAS unsigned char* RT = lds + 108544;
    gla_gates(p, l, BC, GL, tok0, tid);
    {
        const int m = tid >> 3, part = tid & 7; const float rs = 0.17677669529663687f;
        const u32x4* qs = (const u32x4*)(proj + (tok0 + m) * DINP + 1792 + part * 16); const u32x4* ks = (const u32x4*)(proj + (tok0 + m) * DINP + 1920 + part * 16);
#pragma unroll
        for (int i = 0; i < 2; ++i) { const u32x4 qv = qs[i], kv = ks[i]; u32x4 qo, ko;
#pragma unroll
            for (int e = 0; e < 4; ++e) { const int col = part * 16 + i * 8 + e * 2; const float b0 = BC[m * 128 + col], b1 = BC[m * 128 + col + 1];
                qo[e] = pk2(bflo(qv[e]) * rs * __expf(b0), bfhi(qv[e]) * rs * __expf(b1)); ko[e] = pk2(bflo(kv[e]) * __expf(-b0), bfhi(kv[e]) * __expf(-b1)); }
            *(LAS u32x4*)(Qi + (m * 136 + part * 16 + i * 8) * 2) = qo; *(LAS u32x4*)(Ko + (m * 136 + part * 16 + i * 8) * 2) = ko; }
        const u32x4* vs = (const u32x4*)(proj + (tok0 + m) * DINP + 2048 + part * 32);
#pragma unroll
        for (int i = 0; i < 4; ++i) { const u32x4 vv = vs[i];
#pragma unroll
            for (int e = 0; e < 4; ++e) { const int col = part * 32 + i * 8 + e * 2; *(LAS bf16_t*)(VT + (col * 72 + m) * 2) = (bf16_t)(vv[e] & 0xffffu); *(LAS bf16_t*)(VT + ((col + 1) * 72 + m) * 2) = (bf16_t)(vv[e] >> 16); } }
        const int row = tid >> 1, half = tid & 1; const float* rsrc = UC + (size_t)(b * 128 + c) * 8192 + row * 32 + half * 16;
#pragma unroll
        for (int i = 0; i < 2; ++i) { const f32x4 r0 = *(const f32x4*)(rsrc + i * 8), r1 = *(const f32x4*)(rsrc + i * 8 + 4);
            *(LAS u32x4*)(RT + (row * 40 + half * 16 + i * 8) * 2) = (u32x4){pk2(r0[0], r0[1]), pk2(r0[2], r0[3]), pk2(r1[0], r1[1]), pk2(r1[2], r1[3])}; }
    }
    __syncthreads();
    const int c16 = lane & 15, g = lane >> 4, h = w >> 1;
#pragma unroll
    for (int qg = 0; qg < 2; ++qg) {
        const int nblk = (w & 1) * 2 + qg, nn = nblk * 16 + c16;
        const bf16x8 qf = *(const LAS bf16x8*)(Qi + (nn * 136 + h * 32 + g * 8) * 2);
        f32x4 s[4];
#pragma unroll
        for (int kb = 0; kb < 4; ++kb) { s[kb] = (f32x4){0.f, 0.f, 0.f, 0.f};
            if (kb <= nblk) { const bf16x8 a = *(const LAS bf16x8*)(Ko + ((kb * 16 + c16) * 136 + h * 32 + g * 8) * 2); s[kb] = MFMA16(a, qf, s[kb]);
#pragma unroll
                for (int j = 0; j < 4; ++j) if (16 * kb + 4 * g + j > nn) s[kb][j] = 0.f; } }
        f32x4 o[4];
#pragma unroll
        for (int eb = 0; eb < 4; ++eb) { const bf16x8 a = *(const LAS bf16x8*)(RT + ((h * 64 + eb * 16 + c16) * 40 + g * 8) * 2); o[eb] = MFMA16(a, qf, ((f32x4){0.f, 0.f, 0.f, 0.f})); }
#pragma unroll
        for (int pr = 0; pr < 2; ++pr) if (2 * pr <= nblk) {
            const bf16x8 pb = mk8(pk2(s[2 * pr][0], s[2 * pr][1]), pk2(s[2 * pr][2], s[2 * pr][3]), pk2(s[2 * pr + 1][0], s[2 * pr + 1][1]), pk2(s[2 * pr + 1][2], s[2 * pr + 1][3]));
#pragma unroll
            for (int eb = 0; eb < 4; ++eb) { const u32x2 lo = *(const LAS u32x2*)(VT + ((h * 64 + eb * 16 + c16) * 72 + (2 * pr) * 16 + g * 4) * 2), hi = *(const LAS u32x2*)(VT + ((h * 64 + eb * 16 + c16) * 72 + (2 * pr + 1) * 16 + g * 4) * 2);
                o[eb] = MFMA16(mk8(lo[0], lo[1], hi[0], hi[1]), pb, o[eb]); } }
        const size_t tok = tok0 + nn;
        head_norm_store(o, p.in[6] + l * 256 + h * 64, proj + tok * DINP + 2304 + h * 64, Y + tok * DM + 512 + h * 64, g);
    }
    __syncthreads();
}

__device__ __forceinline__ void phase_scans(const Params& p, int l, int tid) {
    const int gid = blockIdx.x * 512 + tid;
    if (gid < 65536) {
        const int b = gid >> 14, h = (gid >> 12) & 3, ed = gid & 4095;
        float* base = (float*)(p.ws + WS_UB) + (size_t)(b * 64 * 4 + h) * 4096 + ed; const float G128 = ex2(128.f * ret_log2g(h)); float r = 0.f;
        for (int c0 = 0; c0 < 64; c0 += 8) { float u[8];
#pragma unroll
            for (int i = 0; i < 8; ++i) u[i] = base[(size_t)(c0 + i) * 16384];
#pragma unroll
            for (int i = 0; i < 8; ++i) { base[(size_t)(c0 + i) * 16384] = r; r = G128 * r + u[i]; } }
    } else if (gid < 98304) {
        const int q = gid - 65536, b = q >> 13, h = (q >> 11) & 3, e = (q >> 5) & 63, d = q & 31;
        float* base = (float*)(p.ws + WS_UC) + (size_t)(b * 128 * 4 + h) * 2048 + e * 32 + d; const float* dc = (const float*)(p.ws + WS_DC) + (size_t)b * 128 * 128 + h * 32 + d; float r = 0.f;
        for (int c0 = 0; c0 < 128; c0 += 8) { float u[8], a[8];
#pragma unroll
            for (int i = 0; i < 8; ++i) { u[i] = base[(size_t)(c0 + i) * 8192]; a[i] = dc[(c0 + i) * 128]; }
#pragma unroll
            for (int i = 0; i < 8; ++i) { base[(size_t)(c0 + i) * 8192] = r; r = a[i] * r + u[i]; } }
    } else if (gid < 102400) {
        const int q = gid - 98304, b = q >> 10, g = (q >> 6) & 15, pp = q & 63;
        const float* ab = (const float*)(p.ws + WS_S5AB) + (size_t)(l * 16 + g) * 128; const float ar = ab[pp], ai = ab[64 + pp];
        const float* E5 = (const float*)(p.ws + WS_E5) + ((size_t)g * 2048 + b * 512) * 128; bf16_t* A5 = (bf16_t*)(p.ws + WS_A5) + ((size_t)g * 2048 + b * 512) * 384 + 256;
        float sr = 0.f, si = 0.f;
        for (int c0 = 0; c0 < 512; c0 += 8) { float er[8], ei[8];
#pragma unroll
            for (int i = 0; i < 8; ++i) { er[i] = E5[(size_t)(c0 + i) * 128 + pp]; ei[i] = E5[(size_t)(c0 + i) * 128 + 64 + pp]; }
#pragma unroll
            for (int i = 0; i < 8; ++i) { A5[(size_t)(c0 + i) * 384 + pp] = (bf16_t)f2bf(sr); A5[(size_t)(c0 + i) * 384 + 64 + pp] = (bf16_t)f2bf(si);
                const float nr = ar * sr - ai * si + er[i], ni = ar * si + ai * sr + ei[i]; sr = nr; si = ni; } }
    }
}

__device__ __forceinline__ void phase_combine(const Params& p, int tid) {
    const bf16_t* OA = (const bf16_t*)(p.ws + WS_OA); const float* LSE = (const float*)(p.ws + WS_LSE); bf16_t* Y = (bf16_t*)(p.ws + WS_Y);
    for (size_t it = (size_t)blockIdx.x * 512 + tid; it < (size_t)T * 32; it += (size_t)gridDim.x * 512) {
        const size_t tok = it >> 5; const int h = (int)(it >> 3) & 3, col = h * 64 + ((int)it & 7) * 8;
        const float l0 = LSE[tok * 4 + h], l1 = LSE[((size_t)T + tok) * 4 + h], l2 = LSE[((size_t)2 * T + tok) * 4 + h];
        const float mx = fmaxf(l0, fmaxf(l1, l2)); float w0 = __expf(l0 - mx), w1 = __expf(l1 - mx), w2 = __expf(l2 - mx); const float inv = 1.f / (w0 + w1 + w2); w0 *= inv; w1 *= inv; w2 *= inv;
        const u32x4 a = *(const u32x4*)(OA + tok * 256 + col), bq = *(const u32x4*)(OA + ((size_t)T + tok) * 256 + col), cq = *(const u32x4*)(OA + ((size_t)2 * T + tok) * 256 + col);
        u32x4 o;
#pragma unroll
        for (int e = 0; e < 4; ++e) o[e] = pk2(w0 * bflo(a[e]) + w1 * bflo(bq[e]) + w2 * bflo(cq[e]), w0 * bfhi(a[e]) + w1 * bfhi(bq[e]) + w2 * bfhi(cq[e]));
        *(u32x4*)(Y + tok * DM + col) = o;
    }
}

__device__ __forceinline__ void phase_ln(const Params& p, const float* gam, const float* bet, int lane, int wave) {
    float* X = p.out; bf16_t* XN = (bf16_t*)(p.ws + WS_XN);
    f32x4 gv[4], bv[4];
#pragma unroll
    for (int j = 0; j < 4; ++j) { gv[j] = *(const f32x4*)(gam + 256 * j + lane * 4); bv[j] = *(const f32x4*)(bet + 256 * j + lane * 4); }
    for (int row = blockIdx.x * 8 + wave; row < T; row += gridDim.x * 8) {
        float* xr = X + (size_t)row * DM + lane * 4; f32x4 v[4]; float s = 0.f;
#pragma unroll
        for (int j = 0; j < 4; ++j) { v[j] = *(const f32x4*)(xr + 256 * j); s += (v[j][0] + v[j][1]) + (v[j][2] + v[j][3]); }
#pragma unroll
        for (int o = 1; o < 64; o <<= 1) s += __shfl_xor(s, o);
        const float mean = s * (1.f / DM); float s2 = 0.f;
#pragma unroll
        for (int j = 0; j < 4; ++j) { v[j] = v[j] - mean; s2 += (v[j][0] * v[j][0] + v[j][1] * v[j][1]) + (v[j][2] * v[j][2] + v[j][3] * v[j][3]); }
#pragma unroll
        for (int o = 1; o < 64; o <<= 1) s2 += __shfl_xor(s2, o);
        const float rstd = rsqrtf(s2 * (1.f / DM) + LN_EPS);
        bf16_t* xn = XN + (size_t)row * DM + lane * 4;
#pragma unroll
        for (int j = 0; j < 4; ++j) { const f32x4 y = v[j] * rstd * gv[j] + bv[j]; *(f32x4*)(xr + 256 * j) = y; st_bf4(xn + 256 * j, y); }
    }
}

__device__ __forceinline__ void grid_barrier(unsigned* ctr, unsigned target, int wave) {
    asm volatile("s_waitcnt vmcnt(0) lgkmcnt(0)" ::: "memory");
    __syncthreads();
    if (wave == 0) {
        int ln; asm volatile("v_mbcnt_lo_u32_b32 %0, -1, 0\n\tv_mbcnt_hi_u32_b32 %0, -1, %0" : "=v"(ln));
        if (ln == 0) {
            __builtin_amdgcn_fence(__ATOMIC_RELEASE, "agent");
            asm volatile("s_waitcnt vmcnt(0)" ::: "memory");
            __hip_atomic_fetch_add(ctr, 1u, __ATOMIC_RELAXED, __HIP_MEMORY_SCOPE_AGENT);
            while (__hip_atomic_load(ctr, __ATOMIC_RELAXED, __HIP_MEMORY_SCOPE_AGENT) < target) __builtin_amdgcn_s_sleep(2);
            __builtin_amdgcn_fence(__ATOMIC_ACQUIRE, "agent");
            asm volatile("s_waitcnt vmcnt(0)" ::: "memory");
        }
    }
    __syncthreads();
}

enum { PH_PRO = 0, PH_KV, PH_MN, PH_L0 };
constexpr int PH_PER_LAYER = 13, PH_TOTAL = PH_L0 + 2 * PH_PER_LAYER;

__global__ void __launch_bounds__(512, 2) mega(Params p_arg, int ph_lo_arg, int ph_hi_arg) {
    extern __shared__ __attribute__((aligned(16))) unsigned char lds_raw[];
    LAS unsigned char* lds = (LAS unsigned char*)lds_raw;
    const int wave = __builtin_amdgcn_readfirstlane((int)threadIdx.x >> 6);
    const int G = gridDim.x, bx = blockIdx.x;
#if !MULTI_LAUNCH
#define SEAM(k) do { if ((k) == 0) { cg::this_grid().sync(); } else { grid_barrier((unsigned*)(kp_->p.ws + WS_BAR), (unsigned)(k) * (unsigned)G, wave); } } while (0)
#else
#define SEAM(k) do {} while (0)
#endif
    typedef const __attribute__((address_space(4))) KArgs* KArgsP;
#define PHASE(k, ...) { KArgsP kp_ = (KArgsP)__builtin_amdgcn_kernarg_segment_ptr(); asm volatile("" : "+s"(kp_)); const int ph_lo = kp_->lo, ph_hi = kp_->hi; \
    if (ph_lo <= (k) && (k) < ph_hi) { Params p; _Pragma("unroll") for (int i_ = 0; i_ < 30; ++i_) p.in[i_] = kp_->p.in[i_]; p.out = kp_->p.out; p.ws = kp_->p.ws; unsigned char* ws = p.ws; bf16_t* XN = (bf16_t*)(ws + WS_XN); bf16_t* Yb = (bf16_t*)(ws + WS_Y); bf16_t* PROJ = (bf16_t*)(ws + WS_PROJ); \
        (void)XN; (void)Yb; (void)PROJ; int lane; asm volatile("v_mbcnt_lo_u32_b32 %0, -1, 0\n\tv_mbcnt_hi_u32_b32 %0, -1, %0" : "=v"(lane)); const int tid = wave * 64 + lane; (void)tid; __VA_ARGS__ if ((k) + 1 < ph_hi) { SEAM(k); } } }
    PHASE(PH_PRO, phase_prologue(p, lds, tid, lane, wave); )
    PHASE(PH_KV, { GKV g{(const bf16_t*)(ws + WS_MEMB), (const bf16_t*)(ws + WS_WKV), 1024, 1024, 1024}; pg8::Sched S; S.init(4, 8, 2, G, bx);
            EpiBf16 E{(bf16_t*)(ws + WS_KV), 2048, 0}; pg8::gemm_phase(lds, g, S, E, wave); } )
    PHASE(PH_MN, { GMT g{(const bf16_t*)(ws + WS_KV), (const bf16_t*)(ws + WS_WQN), 2048, 1024, 256}; pg8::Sched S; S.init(1, 4, 32, G, bx);
              EpiBf16 E{(bf16_t*)(ws + WS_MT), 1024, 1}; pg8::gemm_phase(lds, g, S, E, wave); }
            { GNT g{(const bf16_t*)(ws + WS_WOT), (const bf16_t*)(ws + WS_KV), 1024, 2048, 256}; pg8::Sched S; S.init(4, 1, 32, G, (bx + 128) % G);
              EpiBf16 E{(bf16_t*)(ws + WS_NT), 1024, 2}; pg8::gemm_phase(lds, g, S, E, wave); } )
#define LAYER(l) { const int P0 = PH_L0 + (l) * PH_PER_LAYER; \
    PHASE(P0 + 0, { GPlain g{XN, (const bf16_t*)(ws + WS_WIN) + (size_t)(l) * 3072 * 1024, 1024, 1024, 1024}; pg8::Sched S; S.init(128, 12, 1, G, bx); \
                EpiProj E{PROJ, (bf16_t*)(ws + WS_A5)}; pg8::gemm_phase(lds, g, S, E, wave); } ) \
    PHASE(P0 + 1, for (int t = bx; t < 3072; t += G) attn_task(p, lds, t, tid, lane, wave); \
                for (int t = bx; t < 1024; t += G) ret1_task(p, lds, t, tid, lane, wave); \
                for (int t = bx; t < 512; t += G) gla1_task(p, lds, (l), t, tid, lane, wave); \
                { GS5 g{(const bf16_t*)(ws + WS_A5), (const bf16_t*)(ws + WS_S5E) + (size_t)(l) * 16 * 256 * 256, 384, 256, 256}; pg8::Sched S; S.init(8, 1, 16, G, (bx + 128) % G); \
                  EpiS5E E{(float*)(ws + WS_E5)}; pg8::gemm_phase(lds, g, S, E, wave); } ) \
    PHASE(P0 + 2, phase_scans(p, (l), tid); ) \
    PHASE(P0 + 3, phase_combine(p, tid); \
                for (int t = bx; t < 1024; t += G) ret3_task(p, lds, (l), t, tid, lane, wave); \
                for (int t = bx; t < 512; t += G) gla3_task(p, lds, (l), t, tid, lane, wave); \
                { GS5 g{(const bf16_t*)(ws + WS_A5), (const bf16_t*)(ws + WS_S5Y) + (size_t)(l) * 16 * 256 * 384, 384, 384, 384}; pg8::Sched S; S.init(8, 1, 16, G, (bx + 128) % G); \
                  EpiS5Y E{Yb}; pg8::gemm_phase(lds, g, S, E, wave); } ) \
    PHASE(P0 + 4, { GPlain g{Yb + 768, (const bf16_t*)(ws + WS_WGLU) + (size_t)(l) * 65536, 1024, 256, 256}; pg8::Sched S; S.init(128, 1, 1, G, bx); \
                EpiGLU E{Yb, p.in[16] + (l) * 256}; pg8::gemm_phase(lds, g, S, E, wave); } ) \
    PHASE(P0 + 5, { GPlain g{Yb, (const bf16_t*)(ws + WS_WMIX) + (size_t)(l) * 1024 * 1024, 1024, 1024, 1024}; pg8::Sched S; S.init(128, 4, 1, G, bx); \
                EpiResid E{(l) == 0 ? p.in[0] : p.out, p.out, 0}; pg8::gemm_phase(lds, g, S, E, wave); } ) \
    PHASE(P0 + 6, phase_ln(p, p.in[18] + (l) * 1024, p.in[19] + (l) * 1024, lane, wave); ) \
    PHASE(P0 + 7, { GBatchB g{XN, (const bf16_t*)(ws + WS_MT) + (size_t)(l) * 4 * 1024 * 1024, 1024, 1024, 1024}; pg8::Sched S; S.init(32, 4, 4, G, bx); \
                EpiSoftmax E{PROJ}; pg8::gemm_phase(lds, g, S, E, wave); } ) \
    PHASE(P0 + 8, { GBatchB g{PROJ, (const bf16_t*)(ws + WS_NT) + (size_t)(l) * 4 * 1024 * 1024, 1024, 1024, 1024}; pg8::Sched S; S.init(32, 4, 4, G, bx); \
                EpiResid E{p.out, p.out, 32}; pg8::gemm_phase(lds, g, S, E, wave); } ) \
    PHASE(P0 + 9, phase_ln(p, p.in[23] + (l) * 1024, p.in[24] + (l) * 1024, lane, wave); ) \
    PHASE(P0 + 10, { GPlain g{XN, (const bf16_t*)(ws + WS_WGU) + (size_t)(l) * 5632 * 1024, 1024, 1024, 1024}; pg8::Sched S; S.init(128, 22, 1, G, bx); \
                EpiSwiGLU E{PROJ}; pg8::gemm_phase(lds, g, S, E, wave); } ) \
    PHASE(P0 + 11, { GPlain g{PROJ, (const bf16_t*)(ws + WS_WD) + (size_t)(l) * 1024 * 2816, 2816, 2816, 2816}; pg8::Sched S; S.init(128, 4, 1, G, bx); \
                EpiResid E{p.out, p.out, 0}; pg8::gemm_phase(lds, g, S, E, wave); } ) \
    PHASE(P0 + 12, phase_ln(p, p.in[28] + (l) * 1024, p.in[29] + (l) * 1024, lane, wave); ) }
    LAYER(0)
    LAYER(1)
}

extern "C" void kernel_launch(void* const* d_in, const int* in_sizes, int n_in, void* d_out, int out_size, void* d_ws, size_t ws_size, hipStream_t stream) {
    static int grid = 0;
    if (grid == 0) {
        int dev = 0, cus = 0, per_cu = 0;
        (void)hipGetDevice(&dev); (void)hipDeviceGetAttribute(&cus, hipDeviceAttributeMultiprocessorCount, dev);
        (void)hipFuncSetAttribute((const void*)mega, hipFuncAttributeMaxDynamicSharedMemorySize, LDS_BYTES);
        (void)hipOccupancyMaxActiveBlocksPerMultiprocessor(&per_cu, (const void*)mega, 512, LDS_BYTES);
        if (per_cu < 1) per_cu = 1;
        grid = cus * per_cu;
        if (n_in != 30 || ws_size < WS_END) { fprintf(stderr, "kernel_launch: unexpected n_in %d / ws_size %zu\n", n_in, ws_size); grid = -1; }
    }
    if (grid < 0) return;
    Params p{};
    for (int i = 0; i < 30; ++i) p.in[i] = (const float*)d_in[i];
    p.out = (float*)d_out; p.ws = (unsigned char*)d_ws;
#if !MULTI_LAUNCH
    (void)hipMemsetAsync((char*)d_ws + WS_BAR, 0, 256, stream);
    int lo = 0, hi = PH_TOTAL;
    void* args[] = {&p, &lo, &hi};
    hipError_t e = hipLaunchCooperativeKernel((const void*)mega, dim3(grid), dim3(512), args, LDS_BYTES, stream);
    if (e != hipSuccess) fprintf(stderr, "cooperative launch failed: %s (grid %d)\n", hipGetErrorString(e), grid);
#else
    for (int ph = 0; ph < PH_TOTAL; ++ph) hipLaunchKernelGGL(mega, dim3(grid), dim3(512), LDS_BYTES, stream, p, ph, ph + 1);
#endif
}
```
